# Optimizing an MI355X kernel written in HIP

```python
import jax, jax.numpy as jnp
from jax import lax
import numpy as np

D_MODEL = 1024
BATCH = 2
SEQ = 8192
DEPTH = 1
DEC_BATCH = 128
DEC_SEQ = 1
PAST_LEN = 16384
PAGE_SIZE = 128

D_MIX = D_MODEL
D_ATT = D_MIX // 2
D_POOL = D_MIX - D_ATT
N_HEADS = 8
V_DIM = D_ATT // N_HEADS
NOPE_DIM = 64
ROPE_DIM = 32
QK_DIM = NOPE_DIM + ROPE_DIM
Q_LORA = 256
KV_LORA = 128
ROPE_BASE = 10000.0
POOL_WINDOWS = (2, 4, 8, 16)
N_POOL_GROUPS = len(POOL_WINDOWS)
POOL_GROUP = D_POOL // N_POOL_GROUPS
POOL_PREV = max(POOL_WINDOWS) - 1
Q_BLOCK = 128
EPS = 1e-6
SM_SCALE = QK_DIM ** -0.5
OFF_Q = 0
OFF_KV = OFF_Q + Q_LORA
OFF_KR = OFF_KV + KV_LORA
OFF_GA = OFF_KR + ROPE_DIM
OFF_U = OFF_GA + D_ATT
OFF_GP = OFF_U + D_POOL
D_IN = OFF_GP + D_POOL

kernel_name = "hymba_mla_pool_decode_step"


def rmsnorm(x, w):
    xf = x.astype(jnp.float32)
    y = xf * lax.rsqrt(jnp.mean(xf * xf, axis=-1, keepdims=True) + EPS)
    return (y * w.astype(jnp.float32)).astype(x.dtype)


def rope(x, pos):
    r = x.shape[-1]
    inv = ROPE_BASE ** (-jnp.arange(0, r, 2, dtype=jnp.float32) / r)
    ang = pos.astype(jnp.float32)[:, None] * inv[None, :]
    shp = (ang.shape[0],) + (1,) * (x.ndim - 3) + (r // 2,)
    cos = jnp.cos(ang).reshape(shp)
    sin = jnp.sin(ang).reshape(shp)
    xf = x.astype(jnp.float32)
    x1, x2 = xf[..., : r // 2], xf[..., r // 2:]
    return jnp.concatenate([x1 * cos - x2 * sin, x2 * cos + x1 * sin], axis=-1).astype(x.dtype)


def branch_inputs(x, c, pos, ada_w, ada_b, norm_w, w_in, q_norm_w, w_uq, kv_norm_w):
    mod = jnp.einsum('bd,de->be', jax.nn.silu(c), ada_w) + ada_b
    shift, scale, gate = jnp.split(mod, 3, axis=-1)
    h = rmsnorm(x, norm_w) * (1 + scale[:, None, :]) + shift[:, None, :]
    z = jnp.einsum('btd,de->bte', h, w_in)
    q_lat = rmsnorm(z[..., OFF_Q:OFF_KV], q_norm_w)
    ckv = rmsnorm(z[..., OFF_KV:OFF_KR], kv_norm_w)
    kr = rope(z[..., OFF_KR:OFF_GA], pos)
    g_att = z[..., OFF_GA:OFF_U]
    u = z[..., OFF_U:OFF_GP]
    g_pool = z[..., OFF_GP:]
    q = jnp.einsum('btq,qhd->bthd', q_lat, w_uq)
    q_nope = q[..., :NOPE_DIM]
    q_rope = rope(q[..., NOPE_DIM:], pos)
    return gate, q_nope, q_rope, ckv, kr, g_att, u, g_pool


def attn_prompt(q_nope, q_rope, ckv, kr, w_uk, w_uv):
    b, s = q_nope.shape[:2]
    k_nope = jnp.einsum('bsk,khd->bshd', ckv, w_uk)
    v = jnp.einsum('bsk,khv->bshv', ckv, w_uv)
    nb = s // Q_BLOCK
    qn = q_nope.reshape(b, nb, Q_BLOCK, N_HEADS, NOPE_DIM).transpose(1, 0, 2, 3, 4)
    qr = q_rope.reshape(b, nb, Q_BLOCK, N_HEADS, ROPE_DIM).transpose(1, 0, 2, 3, 4)
    kpos = jnp.arange(s)

    def block(args):
        qn_b, qr_b, i = args
        sc = (jnp.einsum('bqhd,bshd->bhqs', qn_b, k_nope)
              + jnp.einsum('bqhr,bsr->bhqs', qr_b, kr)).astype(jnp.float32) * SM_SCALE
        qpos = i * Q_BLOCK + jnp.arange(Q_BLOCK)
        sc = jnp.where(kpos[None, :] <= qpos[:, None], sc, -jnp.inf)
        p = jax.nn.softmax(sc, axis=-1).astype(v.dtype)
        return jnp.einsum('bhqs,bshv->bqhv', p, v)

    o = lax.map(block, (qn, qr, jnp.arange(nb)))
    return o.transpose(1, 0, 2, 3, 4).reshape(b, s, N_HEADS * V_DIM)


def attn_sample(q_nope, q_rope, ckv, kr, cache_ckv_l, cache_kr_l, page_table, w_uk, w_uv):
    db, t = q_nope.shape[:2]
    past_ckv = cache_ckv_l[page_table].reshape(db, -1, KV_LORA)
    past_kr = cache_kr_l[page_table].reshape(db, -1, ROPE_DIM)
    n_past = past_ckv.shape[1]
    q_abs = jnp.einsum('bthd,khd->bthk', q_nope, w_uk)
    s_past = jnp.einsum('bthk,bsk->bhts', q_abs, past_ckv) + jnp.einsum('bthr,bsr->bhts', q_rope, past_kr)
    s_new = jnp.einsum('bthk,bsk->bhts', q_abs, ckv) + jnp.einsum('bthr,bsr->bhts', q_rope, kr)
    s_new = jnp.where(jnp.tril(jnp.ones((t, t), dtype=bool)), s_new, -jnp.inf)
    sc = jnp.concatenate([s_past, s_new], axis=-1).astype(jnp.float32) * SM_SCALE
    p = jax.nn.softmax(sc, axis=-1).astype(ckv.dtype)
    o_lat = (jnp.einsum('bhts,bsk->bthk', p[..., :n_past], past_ckv)
             + jnp.einsum('bhts,bsk->bthk', p[..., n_past:], ckv))
    o = jnp.einsum('bthk,khv->bthv', o_lat, w_uv)
    return o.reshape(db, t, N_HEADS * V_DIM)


def pool_branch(u, prev, pos0, w_pool, b_pool, pool_scale):
    b, t, _ = u.shape
    u_ext = jnp.concatenate([prev, u], axis=1)
    cs = jnp.cumsum(u_ext.astype(jnp.float32), axis=1)
    cs0 = jnp.concatenate([jnp.zeros((b, 1, D_POOL), jnp.float32), cs], axis=1)
    pos = (pos0 + jnp.arange(t)).astype(jnp.float32)
    outs = []
    for g, w in enumerate(POOL_WINDOWS):
        lo, hi = g * POOL_GROUP, (g + 1) * POOL_GROUP
        wsum = (cs0[:, POOL_PREV + 1:POOL_PREV + 1 + t, lo:hi]
                - cs0[:, POOL_PREV + 1 - w:POOL_PREV + 1 - w + t, lo:hi])
        cnt = jnp.minimum(pos + 1.0, float(w))[None, :, None]
        outs.append(wsum / cnt - u[..., lo:hi].astype(jnp.float32))
    pooled = jnp.stack(outs, axis=2).astype(u.dtype)
    y = jnp.einsum('btgc,gcd->btgd', pooled, w_pool) + b_pool
    y = y.reshape(b, t, D_POOL) * pool_scale
    return y, u_ext[:, -POOL_PREV:]


def combine(x, gate, att, g_att, pool, g_pool, w_out):
    mixed = jnp.concatenate([att * jax.nn.silu(g_att), pool * jax.nn.silu(g_pool)], axis=-1)
    return x + gate[:, None, :] * jnp.einsum('bte,ed->btd', mixed, w_out)


def setup_inputs(seed: int = 0) -> dict:
    key = jax.random.key(seed)
    ks = jax.random.split(key, 32)
    n_pages = PAST_LEN // PAGE_SIZE
    n_pool_pages = (DEC_BATCH * n_pages * 5) // 4
    f32 = jnp.float32
    nrm = lambda k, shp, s=1.0: jax.random.normal(k, shp, f32) * s
    perm = jax.random.permutation(ks[7], n_pool_pages)[: DEC_BATCH * n_pages]
    return {
        "x_prompt": nrm(ks[0], (BATCH, SEQ, D_MODEL)),
        "x_sample": nrm(ks[1], (DEC_BATCH, DEC_SEQ, D_MODEL)),
        "c_prompt": nrm(ks[2], (BATCH, D_MODEL)),
        "c_sample": nrm(ks[3], (DEC_BATCH, D_MODEL)),
        "cache_ckv": nrm(ks[4], (DEPTH, n_pool_pages, PAGE_SIZE, KV_LORA)),
        "cache_krope": nrm(ks[5], (DEPTH, n_pool_pages, PAGE_SIZE, ROPE_DIM)),
        "state_pool": nrm(ks[6], (DEPTH, DEC_BATCH, POOL_PREV, D_POOL)),
        "page_table": perm.reshape(DEC_BATCH, n_pages).astype(jnp.int32),
        "ada_w": nrm(ks[8], (DEPTH, D_MODEL, 3 * D_MODEL), D_MODEL ** -0.5),
        "ada_b": nrm(ks[9], (DEPTH, 3 * D_MODEL), 0.02),
        "norm_w": 1.0 + nrm(ks[10], (DEPTH, D_MODEL), 0.02),
        "w_in": nrm(ks[11], (DEPTH, D_MODEL, D_IN), D_MODEL ** -0.5),
        "q_norm_w": 1.0 + nrm(ks[12], (DEPTH, Q_LORA), 0.02),
        "w_uq": nrm(ks[13], (DEPTH, Q_LORA, N_HEADS, QK_DIM), Q_LORA ** -0.5),
        "kv_norm_w": 1.0 + nrm(ks[14], (DEPTH, KV_LORA), 0.02),
        "w_uk": nrm(ks[15], (DEPTH, KV_LORA, N_HEADS, NOPE_DIM), KV_LORA ** -0.5),
        "w_uv": nrm(ks[16], (DEPTH, KV_LORA, N_HEADS, V_DIM), KV_LORA ** -0.5),
        "w_pool": nrm(ks[17], (DEPTH, N_POOL_GROUPS, POOL_GROUP, POOL_GROUP), POOL_GROUP ** -0.5),
        "b_pool": nrm(ks[18], (DEPTH, N_POOL_GROUPS, POOL_GROUP), 0.01),
        "pool_scale": 1.0 + nrm(ks[19], (DEPTH, D_POOL), 0.05),
        "w_out": nrm(ks[20], (DEPTH, D_MIX, D_MODEL), D_MIX ** -0.5),
        "final_norm_w": 1.0 + nrm(ks[21], (D_MODEL,), 0.02),
    }


def reference(x_prompt, x_sample, c_prompt, c_sample, cache_ckv, cache_krope, state_pool, page_table,
              ada_w, ada_b, norm_w, w_in, q_norm_w, w_uq, kv_norm_w, w_uk, w_uv,
              w_pool, b_pool, pool_scale, w_out, final_norm_w):
    pos_p = jnp.arange(x_prompt.shape[1])
    pos_s = PAST_LEN + jnp.arange(x_sample.shape[1])
    xp, xs = x_prompt, x_sample
    ckv_p_l, kr_p_l, pool_p_l, ckv_s_l, kr_s_l, pool_s_l = [], [], [], [], [], []
    for l in range(DEPTH):
        gate, qn, qr, ckv, kr, g_att, u, g_pool = branch_inputs(
            xp, c_prompt, pos_p, ada_w[l], ada_b[l], norm_w[l], w_in[l], q_norm_w[l], w_uq[l], kv_norm_w[l])
        att = attn_prompt(qn, qr, ckv, kr, w_uk[l], w_uv[l])
        prev0 = jnp.zeros((xp.shape[0], POOL_PREV, D_POOL), u.dtype)
        pool, new_prev = pool_branch(u, prev0, 0, w_pool[l], b_pool[l], pool_scale[l])
        xp = combine(xp, gate, att, g_att, pool, g_pool, w_out[l])
        ckv_p_l.append(ckv); kr_p_l.append(kr); pool_p_l.append(new_prev)
        gate, qn, qr, ckv, kr, g_att, u, g_pool = branch_inputs(
            xs, c_sample, pos_s, ada_w[l], ada_b[l], norm_w[l], w_in[l], q_norm_w[l], w_uq[l], kv_norm_w[l])
        att = attn_sample(qn, qr, ckv, kr, cache_ckv[l], cache_krope[l], page_table, w_uk[l], w_uv[l])
        pool, new_prev = pool_branch(u, state_pool[l], PAST_LEN, w_pool[l], b_pool[l], pool_scale[l])
        xs = combine(xs, gate, att, g_att, pool, g_pool, w_out[l])
        ckv_s_l.append(ckv); kr_s_l.append(kr); pool_s_l.append(new_prev)
    y_prompt = rmsnorm(xp, final_norm_w)
    y_sample = rmsnorm(xs, final_norm_w)
    return (y_prompt, y_sample,
            jnp.stack(ckv_p_l), jnp.stack(kr_p_l), jnp.stack(pool_p_l),
            jnp.stack(ckv_s_l), jnp.stack(kr_s_l), jnp.stack(pool_s_l))
```

```cpp
#include <hip/hip_runtime.h>
#include <cstdio>
#include <cstdint>

#ifndef MK_N_LAUNCHES
#define MK_N_LAUNCHES 1
#endif
constexpr int N_PHASES = 8;

constexpr int DM = 1024, SEQ = 8192, NB = 2, MP = NB * SEQ, DB = 128, MT = MP + DB;
constexpr int NH = 8, QL = 256, KVL = 128, DPOOL = 512;
constexpr int OFF_Q = 0, OFF_KV = 256, OFF_KR = 384, OFF_GA = 416, OFF_U = 928, OFF_GP = 1440, DIN = 1952, ZP = 2048;
constexpr float EPS = 1e-6f;
constexpr float SM_SCALE = 0.10206207261596575f;
constexpr float C2 = SM_SCALE * 1.4426950408889634f;
constexpr size_t O_YP = 0, O_YS = 16777216, O_CKVP = 16908288, O_KRP = 19005440, O_POOLP = 19529728, O_CKVS = 19545088, O_KRS = 19561472, O_POOLS = 19565568;
constexpr size_t MiB = 1u << 20;
constexpr size_t WS_CTL = 0, CTL_ZERO_BYTES = 1 * MiB;
constexpr size_t WS_MOD = 1 * MiB, WS_ROPE = 3 * MiB, WS_WIN = 5 * MiB, WS_WOUT = 9 * MiB, WS_WUQF = 11 * MiB, WS_WKVF = 11 * MiB + 512 * 1024, WS_WPF = 12 * MiB;
constexpr size_t WS_PART = 13 * MiB, WS_SAMP = 15 * MiB, WS_H = 16 * MiB, WS_Z = 49 * MiB, WS_Q = 114 * MiB, WS_K = 138 * MiB, WS_V = 162 * MiB, WS_MIX = 178 * MiB, WS_END = 211 * MiB;
constexpr int CW_BAR = 4096;
constexpr int RING_BYTES = 131072, LDSCTL_OFF = RING_BYTES, MISC_OFF = LDSCTL_OFF + 320, LDS_BYTES = 147456;

#define LAS __attribute__((address_space(3)))
typedef unsigned short bf16_t;
typedef short bf16x8 __attribute__((ext_vector_type(8)));
typedef short s16x4 __attribute__((ext_vector_type(4)));
typedef float f32x4 __attribute__((ext_vector_type(4)));
typedef float f32x2 __attribute__((ext_vector_type(2)));
typedef float f32x16 __attribute__((ext_vector_type(16)));
typedef unsigned u32x4 __attribute__((ext_vector_type(4)));
typedef unsigned u32x2 __attribute__((ext_vector_type(2)));

struct Params {
    const float* x_p; const float* x_s; const float* c_p; const float* c_s;
    const float* cache_ckv; const float* cache_kr; const float* state_pool; const int* page_table;
    const float* ada_w; const float* ada_b; const float* norm_w; const float* w_in; const float* q_norm_w;
    const float* w_uq; const float* kv_norm_w; const float* w_uk; const float* w_uv; const float* w_pool;
    const float* b_pool; const float* pool_scale; const float* w_out; const float* final_norm_w;
    float* out; unsigned char* ws;
    int ph_lo, ph_hi;
};

__device__ __forceinline__ float bf2f(bf16_t b) { return __uint_as_float(((unsigned)b) << 16); }
__device__ __forceinline__ float bflo(unsigned w) { return __uint_as_float(w << 16); }
__device__ __forceinline__ float bfhi(unsigned w) { return __uint_as_float(w & 0xffff0000u); }
__device__ __forceinline__ unsigned pkbf(float lo, float hi) { unsigned r; asm("v_cvt_pk_bf16_f32 %0, %1, %2" : "=v"(r) : "v"(lo), "v"(hi)); return r; }
__device__ __forceinline__ bf16_t f2bf(float f) { return (bf16_t)(pkbf(f, 0.f) & 0xffffu); }
__device__ __forceinline__ float silu_f(float x) { return x / (1.f + __expf(-x)); }
__device__ __forceinline__ float wave_sum(float v) {
#pragma unroll
    for (int o = 1; o < 64; o <<= 1) v += __shfl_xor(v, o);
    return v;
}
__device__ __forceinline__ int crow(int r, int hi) { return (r & 3) + 8 * (r >> 2) + 4 * hi; }
#define SBAR() __builtin_amdgcn_sched_barrier(0)

namespace pg8 {
constexpr int BM = 256, BK = 64, HALF = 128, HTB = HALF * BK * 2, STAGE_BYTES = 8 * HTB, NXCD = 8, WGM = 8;
__host__ __device__ __forceinline__ int lds_byte(int r, int c) { const int st = (r >> 4) * 2 + (c >> 5), rr = r & 15, cc = c & 31, ob = rr * 64 + cc * 2; return st * 1024 + (ob ^ (((ob >> 9) & 1) << 5)); }
__host__ __device__ __forceinline__ void stage_rc(int b, int& R, int& C) { const int st = b / 1024, sb = b % 1024, swz = sb ^ (((sb >> 9) & 1) << 5); R = (st >> 1) * 16 + swz / 64; C = (st & 1) * 32 + (swz % 64) / 2; }
__host__ __device__ __forceinline__ int perm32(int rho) { const int n = rho >> 4, i = rho & 15; return 8 * (i >> 2) + 4 * n + (i & 3); }
struct Unit { int pm, pn; };
struct Gemm { const bf16_t* A; const bf16_t* Bt; int M, N, K; };
struct StaticOrder {
    int nM, nN, nwg, G, c;
    __host__ __device__ void init(int M, int N, int G_, int c_) { nM = M / BM; nN = N / BM; nwg = nM * nN; G = G_; c = c_; }
    __host__ __device__ bool next(int i, Unit& u) const {
        const long L = (long)i * G + c; if (L >= nwg) return false;
        int wgid = (int)L; { const int q = nwg / NXCD, r = nwg % NXCD, xcd = wgid % NXCD, off = wgid / NXCD; wgid = (xcd < r ? xcd * (q + 1) : r * (q + 1) + (xcd - r) * q) + off; }
        const int nig = WGM * nN, gid = wgid / nig, fm = gid * WGM, gsz = (nM - fm) < WGM ? (nM - fm) : WGM;
        u.pm = fm + ((wgid % nig) % gsz); u.pn = (wgid % nig) / gsz; return true;
    }
    __device__ __forceinline__ void a_ready(const Unit&) const {}
    __device__ __forceinline__ void done(const Unit&) const {}
};
struct EpiBf16 {
    static constexpr bool PERM = true, AFTER_DRAIN = false;
    bf16_t* O; int ldc;
    __device__ __forceinline__ void operator()(const f32x4 (&acc)[2][2][4][2], const Unit& u, int wr, int wc, int fr, int fq) const {
        const int row0 = u.pm * BM + wr * 64 + fr; const int col0 = u.pn * BM + wc * 32 + 8 * fq;
#pragma unroll
        for (int ai = 0; ai < 2; ++ai)
#pragma unroll
            for (int m = 0; m < 4; ++m) { bf16_t* rowp = O + (size_t)(row0 + ai * HALF + m * 16) * ldc + col0;
#pragma unroll
                for (int bj = 0; bj < 2; ++bj) { const f32x4 v0 = acc[ai][bj][m][0], v1 = acc[ai][bj][m][1];
                    u32x4 w; w.x = pkbf(v0[0], v0[1]); w.y = pkbf(v0[2], v0[3]); w.z = pkbf(v1[0], v1[1]); w.w = pkbf(v1[2], v1[3]);
                    *(u32x4*)(rowp + bj * HALF) = w; } }
    }
};
struct EpiOut {
    static constexpr bool PERM = false, AFTER_DRAIN = false;
    const float* x; const float* mod; float* out;
    __device__ __forceinline__ void operator()(const f32x4 (&acc)[2][2][4][2], const Unit& u, int wr, int wc, int fr, int fq) const {
        const int row0 = u.pm * BM + wr * 64 + fr; const int col0 = u.pn * BM + wc * 32 + 4 * fq;
        const float* gp = mod + (size_t)(row0 >> 13) * 3072 + 2048 + col0;
        f32x4 g[2][2];
#pragma unroll
        for (int bj = 0; bj < 2; ++bj)
#pragma unroll
            for (int n = 0; n < 2; ++n) g[bj][n] = *(const f32x4*)(gp + bj * HALF + n * 16);
#pragma unroll
        for (int ai = 0; ai < 2; ++ai)
#pragma unroll
            for (int m = 0; m < 4; ++m) { const size_t off = (size_t)(row0 + ai * HALF + m * 16) * DM + col0;
#pragma unroll
                for (int bj = 0; bj < 2; ++bj)
#pragma unroll
                    for (int n = 0; n < 2; ++n) { const f32x4 xv = *(const f32x4*)(x + off + bj * HALF + n * 16);
                        *(f32x4*)(out + off + bj * HALF + n * 16) = xv + g[bj][n] * acc[ai][bj][m][n]; } }
    }
};

template <class Epi, class Sched, bool ALIGN_EPI = false, bool SP2 = false>
__device__ __forceinline__ void gemm_phase(LAS unsigned char* lds, const Gemm g, const Sched& S, const Epi& E) {
    const int tid = threadIdx.x, wid = __builtin_amdgcn_readfirstlane(tid >> 6), lane = tid & 63, wr = wid >> 2, wc = wid & 3, fr = lane & 15, fq = lane >> 4;
    const int K = g.K, nt = K / BK;
    unsigned voffA[2], voffB[2];
#pragma unroll
    for (int i = 0; i < 2; ++i) { int R, C; stage_rc(tid * 16 + i * 8192, R, C); const int Rb = Epi::PERM ? ((R & ~31) + perm32(R & 31)) : R;
        voffA[i] = (unsigned)(R * K + C) * 2u; voffB[i] = (unsigned)(Rb * K + C) * 2u; }
    const size_t kstep = (size_t)(BK * 2);
    const size_t hstep = (size_t)HALF * K * 2;
    const size_t tstep = 2 * hstep;
    const unsigned ldsw = (unsigned)wid * 1024u;
    const int aoff = lds_byte(wr * 64 + fr, fq * 8), boff = lds_byte(wc * 32 + fr, fq * 8);
#define PG8_SA(b, h) (((b) * 2 + (h)) * HTB)
#define PG8_SB(b, h) ((4 + (b) * 2 + (h)) * HTB)
#define PG8_STAGE(bufoff, gbase, voff) do { _Pragma("unroll") for (int _i = 0; _i < 2; ++_i) \
        __builtin_amdgcn_global_load_lds((const unsigned*)((const char*)(gbase) + (voff)[_i]), (LAS unsigned*)(lds + (bufoff) + ldsw + _i * 8192), 16, 0, 0); } while (0)
#define PG8_LDA(dst, b, h) do { _Pragma("unroll") for (int m = 0; m < 4; ++m) _Pragma("unroll") for (int k = 0; k < 2; ++k) dst[m][k] = *(const LAS bf16x8*)(lds + PG8_SA(b, h) + aoff + m * 2048 + k * 1024); } while (0)
#define PG8_LDB(dst, b, h) do { _Pragma("unroll") for (int n = 0; n < 2; ++n) _Pragma("unroll") for (int k = 0; k < 2; ++k) dst[n][k] = *(const LAS bf16x8*)(lds + PG8_SB(b, h) + boff + n * 2048 + k * 1024); } while (0)
#define PG8_MMA(ai, bj, At, Bt) do { __builtin_amdgcn_s_setprio(1); _Pragma("unroll") for (int m = 0; m < 4; ++m) _Pragma("unroll") for (int n = 0; n < 2; ++n) _Pragma("unroll") for (int k = 0; k < 2; ++k) \
        acc[ai][bj][m][n] = __builtin_amdgcn_mfma_f32_16x16x32_bf16(Bt[n][k], At[m][k], acc[ai][bj][m][n], 0, 0, 0); __builtin_amdgcn_s_setprio(0); } while (0)
#define PG8_WAIT_V(n) asm volatile("s_waitcnt vmcnt(" #n ")" ::: "memory")
#define PG8_WAIT_L(n) asm volatile("s_waitcnt lgkmcnt(" #n ")" ::: "memory")
#define PG8_BAR __builtin_amdgcn_s_barrier()
#define PG8_SCHED __builtin_amdgcn_sched_barrier(0)
    Unit cur, nxt; int ui = 0;
    if (!S.next(0, cur)) return;
    f32x4 acc[2][2][4][2];
#pragma unroll
    for (int a = 0; a < 2; ++a)
#pragma unroll
        for (int b = 0; b < 2; ++b)
#pragma unroll
            for (int m = 0; m < 4; ++m)
#pragma unroll
                for (int n = 0; n < 2; ++n) acc[a][b][m][n] = (f32x4){0.f, 0.f, 0.f, 0.f};
    bf16x8 At[4][2], B0[2][2], B1[2][2];
    const char* cA = (const char*)g.A + (size_t)cur.pm * tstep; const char* cB = (const char*)g.Bt + (size_t)cur.pn * tstep;
    S.a_ready(cur);
    if constexpr (SP2) {
        PG8_STAGE(PG8_SB(0, 0), cB, voffB); PG8_STAGE(PG8_SB(0, 1), cB + hstep, voffB); PG8_STAGE(PG8_SA(0, 0), cA, voffA); PG8_STAGE(PG8_SA(0, 1), cA + hstep, voffA);
        if (wr == 1) PG8_BAR;
        PG8_WAIT_V(2); PG8_BAR;
        PG8_STAGE(PG8_SB(1, 0), cB + kstep, voffB); PG8_STAGE(PG8_SA(1, 0), cA + kstep, voffA); PG8_STAGE(PG8_SB(1, 1), cB + hstep + kstep, voffB);
        PG8_WAIT_V(6); PG8_BAR;
    } else {
        PG8_STAGE(PG8_SB(0, 0), cB, voffB); PG8_STAGE(PG8_SA(0, 0), cA, voffA); PG8_STAGE(PG8_SB(0, 1), cB + hstep, voffB); PG8_STAGE(PG8_SA(0, 1), cA + hstep, voffA);
        if (wr == 1) PG8_BAR;
        PG8_WAIT_V(4); PG8_BAR;
        PG8_STAGE(PG8_SB(1, 0), cB + kstep, voffB); PG8_STAGE(PG8_SA(1, 0), cA + kstep, voffA); PG8_STAGE(PG8_SB(1, 1), cB + hstep + kstep, voffB);
        PG8_WAIT_V(6); PG8_BAR;
    }
    for (;;) {
        const bool has_next = S.next(ui + 1, nxt);
        const char* nA = has_next ? (const char*)g.A + (size_t)nxt.pm * tstep : cA; const char* nB = has_next ? (const char*)g.Bt + (size_t)nxt.pn * tstep : cB;
        for (int t = 0; t < nt; t += 2) {
            const bool last = (t == nt - 2);
            const char* a1 = cA + (size_t)(t + 1) * kstep;
            const char* a2 = last ? nA : cA + (size_t)(t + 2) * kstep; const char* b2 = last ? nB : cB + (size_t)(t + 2) * kstep;
            const char* a3 = a2 + kstep; const char* b3 = b2 + kstep;
            if (last && has_next) S.a_ready(nxt);
            if constexpr (SP2) {
            PG8_LDB(B0, 0, 0); PG8_LDB(B1, 0, 1); PG8_SCHED; PG8_LDA(At, 0, 0); PG8_STAGE(PG8_SA(1, 1), a1 + hstep, voffA);
            PG8_WAIT_V(8); PG8_WAIT_L(0); PG8_BAR; PG8_MMA(0, 0, At, B0); PG8_MMA(0, 1, At, B1); PG8_BAR; PG8_SCHED;
            PG8_LDA(At, 0, 1); PG8_STAGE(PG8_SB(0, 0), b2, voffB); PG8_STAGE(PG8_SB(0, 1), b2 + hstep, voffB); PG8_STAGE(PG8_SA(0, 0), a2, voffA);
            PG8_WAIT_V(8); PG8_WAIT_L(0); PG8_BAR; PG8_MMA(1, 0, At, B0); PG8_MMA(1, 1, At, B1); PG8_BAR; PG8_SCHED;
            PG8_LDB(B0, 1, 0); PG8_LDB(B1, 1, 1); PG8_SCHED; PG8_LDA(At, 1, 0); PG8_STAGE(PG8_SA(0, 1), a2 + hstep, voffA);
            PG8_WAIT_V(8); PG8_WAIT_L(0); PG8_BAR; PG8_MMA(0, 0, At, B0); PG8_MMA(0, 1, At, B1); PG8_BAR; PG8_SCHED;
            PG8_LDA(At, 1, 1); PG8_STAGE(PG8_SB(1, 0), b3, voffB); PG8_STAGE(PG8_SB(1, 1), b3 + hstep, voffB); PG8_STAGE(PG8_SA(1, 0), a3, voffA);
            PG8_WAIT_V(8); PG8_WAIT_L(0); PG8_BAR; PG8_MMA(1, 0, At, B0); PG8_MMA(1, 1, At, B1); PG8_BAR; PG8_SCHED;
            } else {
            PG8_LDB(B0, 0, 0); PG8_SCHED; PG8_LDA(At, 0, 0); PG8_STAGE(PG8_SA(1, 1), a1 + hstep, voffA);
            PG8_WAIT_L(8); PG8_BAR; PG8_WAIT_L(0); PG8_MMA(0, 0, At, B0); PG8_BAR; PG8_SCHED;
            PG8_LDB(B1, 0, 1); PG8_STAGE(PG8_SB(0, 0), b2, voffB);
            PG8_BAR; PG8_WAIT_L(0); PG8_MMA(0, 1, At, B1); PG8_BAR;
            PG8_LDA(At, 0, 1); PG8_STAGE(PG8_SA(0, 0), a2, voffA);
            PG8_BAR; PG8_WAIT_L(0); PG8_MMA(1, 0, At, B0); PG8_BAR; PG8_SCHED;
            PG8_STAGE(PG8_SB(0, 1), b2 + hstep, voffB);
            PG8_WAIT_V(6); PG8_BAR; PG8_MMA(1, 1, At, B1); PG8_BAR;
            PG8_LDB(B0, 1, 0); PG8_SCHED; PG8_LDA(At, 1, 0); PG8_STAGE(PG8_SA(0, 1), a2 + hstep, voffA);
            PG8_WAIT_L(8); PG8_BAR; PG8_WAIT_L(0); PG8_MMA(0, 0, At, B0); PG8_BAR; PG8_SCHED;
            PG8_LDB(B1, 1, 1); PG8_STAGE(PG8_SB(1, 0), b3, voffB);
            PG8_BAR; PG8_WAIT_L(0); PG8_MMA(0, 1, At, B1); PG8_BAR;
            PG8_LDA(At, 1, 1); PG8_STAGE(PG8_SA(1, 0), a3, voffA);
            PG8_BAR; PG8_WAIT_L(0); PG8_MMA(1, 0, At, B0); PG8_BAR; PG8_SCHED;
            PG8_STAGE(PG8_SB(1, 1), b3 + hstep, voffB);
            PG8_WAIT_V(6); PG8_BAR; PG8_MMA(1, 1, At, B1); PG8_BAR;
            }
        }
        if constexpr (ALIGN_EPI) { if (wr == 0) PG8_BAR; }
        if constexpr (!Epi::AFTER_DRAIN) { E(acc, cur, wr, wc, fr, fq); S.done(cur); }
        if (!has_next) break;
#pragma unroll
        for (int a = 0; a < 2; ++a)
#pragma unroll
            for (int b = 0; b < 2; ++b)
#pragma unroll
                for (int m = 0; m < 4; ++m)
#pragma unroll
                    for (int n = 0; n < 2; ++n) acc[a][b][m][n] = (f32x4){0.f, 0.f, 0.f, 0.f};
        cur = nxt; cA = nA; cB = nB; ++ui;
        if constexpr (ALIGN_EPI) { if (wr == 1) PG8_BAR; }
    }
    PG8_WAIT_V(0);
    if constexpr (!ALIGN_EPI) { if (wr == 0) PG8_BAR; }
    PG8_BAR;
#undef PG8_SA
#undef PG8_SB
#undef PG8_STAGE
#undef PG8_LDA
#undef PG8_LDB
#undef PG8_MMA
#undef PG8_WAIT_V
#undef PG8_WAIT_L
#undef PG8_BAR
#undef PG8_SCHED
}
}

#define XB_TMO      128
#define XB_XCNT(j)  (256  + 64 * (j))
#define XB_XSUB(j)  (1280 + 64 * (j))
#define XB_XGEN(j)  (2304 + 64 * (j))
#define XB_TOP      3328
#define XB_TOPGEN   3392
#define XCD_BAR_WORDS 3456
#define XB_SPIN_CAP (1u << 18)
__device__ __forceinline__ unsigned xb_ld(unsigned* p)              { return __hip_atomic_load(p, __ATOMIC_RELAXED, __HIP_MEMORY_SCOPE_AGENT); }
__device__ __forceinline__ unsigned xb_add(unsigned* p, unsigned v) { return __hip_atomic_fetch_add(p, v, __ATOMIC_RELAXED, __HIP_MEMORY_SCOPE_AGENT); }
__device__ __forceinline__ unsigned xb_xcc_id() { return (unsigned)__builtin_amdgcn_s_getreg((3 << 11) | 20) & 0xFu; }
#define XB_SPIN(cond, bar) do { unsigned _sp = 0; while (cond) { __builtin_amdgcn_s_sleep(1); \
    if ((++_sp & 255u) == 0u) { if (xb_ld(&(bar)[XB_TMO])) break; if (_sp > XB_SPIN_CAP) { atomicAdd(&(bar)[XB_TMO], 1u); break; } } } } while (0)
struct XcdBarrier { unsigned* bar; unsigned x; volatile LAS unsigned* st; };
__device__ __forceinline__ XcdBarrier xcd_barrier_post(unsigned* bar, volatile LAS unsigned* st) {
    XcdBarrier b; b.bar = bar; b.x = xb_xcc_id(); b.st = st;
    if (threadIdx.x == 0) (void)xb_add(&bar[XB_XCNT(b.x)], 1u);
    return b;
}
__device__ __forceinline__ void xcd_barrier_complete(unsigned* bar, unsigned x, unsigned& nloc, unsigned& nx) {
    const unsigned G = gridDim.x * gridDim.y * gridDim.z;
    unsigned sum, cnt, mine, sp = 0u;
    for (;;) {
        sum = 0u; cnt = 0u; mine = 0u;
#pragma unroll
        for (unsigned j = 0; j < 16; ++j) { const unsigned c = xb_ld(&bar[XB_XCNT(j)]); sum += c; cnt += (c > 0u) ? 1u : 0u; mine = (j == x) ? c : mine; }
        if (sum == G) break;
        __builtin_amdgcn_s_sleep(1);
        if ((++sp & 255u) == 0u) { if (xb_ld(&bar[XB_TMO])) break; if (sp > XB_SPIN_CAP) { atomicAdd(&bar[XB_TMO], 1u); break; } }
    }
    nloc = mine > 0u ? mine : 1u; nx = cnt > 0u ? cnt : 1u;
}
__device__ __forceinline__ void xcd_barrier(const XcdBarrier& b) {
    asm volatile("s_waitcnt vmcnt(0)" ::: "memory");
    __syncthreads();
    if (threadIdx.x == 0) {
        unsigned* bar = b.bar;
        __builtin_amdgcn_s_waitcnt(0);
        unsigned nloc = b.st[0], nx = b.st[1];
        if (nloc == 0u) { xcd_barrier_complete(bar, b.x, nloc, nx); b.st[0] = nloc; b.st[1] = nx; }
        const unsigned old = xb_add(&bar[XB_XSUB(b.x)], 1u);
        const unsigned gen = old / nloc;
        if (old + 1u == (gen + 1u) * nloc) {
            __builtin_amdgcn_fence(__ATOMIC_RELEASE, "agent");
            asm volatile("s_waitcnt vmcnt(0)" ::: "memory");
            const unsigned og = xb_add(&bar[XB_TOP], 1u);
            const unsigned tg = og / nx;
            if (og + 1u == (tg + 1u) * nx) xb_add(&bar[XB_TOPGEN], 1u);
            else XB_SPIN(xb_ld(&bar[XB_TOPGEN]) == tg, bar);
            __builtin_amdgcn_fence(__ATOMIC_ACQUIRE, "agent");
            xb_add(&bar[XB_XGEN(b.x)], 1u);
            asm volatile("s_waitcnt vmcnt(0)" ::: "memory");
        } else {
            XB_SPIN(xb_ld(&bar[XB_XGEN(b.x)]) == gen, bar);
            __builtin_amdgcn_fence(__ATOMIC_ACQUIRE, "agent");
            asm volatile("s_waitcnt vmcnt(0)" ::: "memory");
        }
    }
    __syncthreads();
}

struct Frame {
    unsigned char* lds;
    int tid, lane, wave, vcu, G, gw, ngw;
    float* mod; float* rope; bf16_t* WinT; bf16_t* WoutT; bf16_t* WuqF; bf16_t* WkvF; bf16_t* WpF;
    float* part; float* samp; bf16_t* H; bf16_t* Z; bf16_t* Q; bf16_t* Kt; bf16_t* Vt; bf16_t* MIX;
};

__device__ __forceinline__ void fresh(Frame& F) { int t = F.tid; asm volatile("" : "+v"(t)); F.tid = t; F.lane = t & 63; }
__constant__ float ROPE_INV[16] = {1.000000000e+00f, 5.623413324e-01f, 3.162277639e-01f, 1.778279394e-01f, 1.000000015e-01f, 5.623413250e-02f, 3.162277490e-02f, 1.778279431e-02f,
                                   9.999999776e-03f, 5.623413250e-03f, 3.162277630e-03f, 1.778279431e-03f, 1.000000047e-03f, 5.623413017e-04f, 3.162277571e-04f, 1.778279402e-04f};

__device__ __forceinline__ void p0_mod_unit(const Params& p, Frame& F, int unit) {
    fresh(F);
    const int cb = unit % 48, rc = unit / 48;
    float* sc = (float*)F.lds;
    for (int i = 0; i < 16; ++i) {
        const int idx4 = F.tid + 512 * i, r = idx4 >> 8, k4 = idx4 & 255;
        f32x4 v = {0.f, 0.f, 0.f, 0.f};
        if (rc < 4) v = *(const f32x4*)(p.c_s + (size_t)(32 * rc + r) * DM + 4 * k4);
        else if (r < NB) v = *(const f32x4*)(p.c_p + (size_t)r * DM + 4 * k4);
        v.x = silu_f(v.x); v.y = silu_f(v.y); v.z = silu_f(v.z); v.w = silu_f(v.w);
        *(f32x4*)(sc + r * 1024 + 4 * k4) = v;
    }
    __syncthreads();
    float acc[32];
#pragma unroll
    for (int r = 0; r < 32; ++r) acc[r] = 0.f;
    const int col = 64 * cb + F.lane, kbase = 128 * F.wave;
    const float* wp = p.ada_w + (size_t)kbase * 3072 + col;
#pragma unroll 2
    for (int k4 = 0; k4 < 32; ++k4) {
        const float w0 = wp[(size_t)(4 * k4 + 0) * 3072], w1 = wp[(size_t)(4 * k4 + 1) * 3072], w2 = wp[(size_t)(4 * k4 + 2) * 3072], w3 = wp[(size_t)(4 * k4 + 3) * 3072];
#pragma unroll
        for (int r = 0; r < 32; ++r) { const f32x4 s = *(const f32x4*)(sc + r * 1024 + kbase + 4 * k4); acc[r] += s.x * w0 + s.y * w1 + s.z * w2 + s.w * w3; }
    }
    __syncthreads();
    float* part = (float*)F.lds;
#pragma unroll
    for (int r = 0; r < 32; ++r) part[(F.wave * 32 + r) * 64 + F.lane] = acc[r];
    __syncthreads();
    for (int i = 0; i < 4; ++i) {
        const int o = F.tid + 512 * i, r = o >> 6, c = o & 63;
        float s = 0.f;
#pragma unroll
        for (int w = 0; w < 8; ++w) s += part[(w * 32 + r) * 64 + c];
        s += p.ada_b[64 * cb + c];
        if (rc < 4) F.mod[(size_t)(2 + 32 * rc + r) * 3072 + 64 * cb + c] = s;
        else if (r < NB) F.mod[(size_t)r * 3072 + 64 * cb + c] = s;
    }
    __syncthreads();
}
__device__ __forceinline__ void p0_transpose_item(const float* W, int K, int N, bf16_t* WT, float* scr, int item, int lane) {
    const int nblk = N / 32, kb = item / nblk, nb = item % nblk, k0 = 64 * kb, n0 = 32 * nb;
#pragma unroll 8
    for (int i = 0; i < 32; ++i) { const int kk = 2 * i + (lane >> 5); scr[kk * 33 + (lane & 31)] = W[(size_t)(k0 + kk) * N + n0 + (lane & 31)]; }
    asm volatile("s_waitcnt lgkmcnt(0)" ::: "memory");
    const int c = lane & 7;
#pragma unroll
    for (int j = 0; j < 4; ++j) { const int n = (lane >> 3) + 8 * j; const float* s = scr + (8 * c) * 33 + n;
        u32x4 o; o.x = pkbf(s[0 * 33], s[1 * 33]); o.y = pkbf(s[2 * 33], s[3 * 33]); o.z = pkbf(s[4 * 33], s[5 * 33]); o.w = pkbf(s[6 * 33], s[7 * 33]);
        *(u32x4*)(WT + (size_t)(n0 + n) * K + k0 + 8 * c) = o; }
    asm volatile("s_waitcnt lgkmcnt(0)" ::: "memory");
}
__device__ __forceinline__ void sincos_d(float angf, float& s_out, float& c_out) {
    const double a = (double)angf;
    const double nq = __builtin_rint(a * 0.6366197723675814);
    double r = a - nq * 1.5707963267948966; r -= nq * 6.123233995736766e-17;
    const double r2 = r * r;
    double s = 1.0 / 6227020800.0; s = s * r2 - 1.0 / 39916800.0; s = s * r2 + 1.0 / 362880.0; s = s * r2 - 1.0 / 5040.0; s = s * r2 + 1.0 / 120.0; s = s * r2 - 1.0 / 6.0; s = s * r2 + 1.0; s *= r;
    double c = -1.0 / 87178291200.0; c = c * r2 + 1.0 / 479001600.0; c = c * r2 - 1.0 / 3628800.0; c = c * r2 + 1.0 / 40320.0; c = c * r2 - 1.0 / 720.0; c = c * r2 + 1.0 / 24.0; c = c * r2 - 0.5; c = c * r2 + 1.0;
    const int q = ((int)nq) & 3;
    const double ss = (q == 0) ? s : (q == 1) ? c : (q == 2) ? -s : -c;
    const double cc = (q == 0) ? c : (q == 1) ? -s : (q == 2) ? -c : s;
    s_out = (float)ss; c_out = (float)cc;
}
template <class SrcFn> __device__ __forceinline__ void frag_piece(bf16_t* dst, int piece, int nks, SrcFn src) {
    const int lane = piece & 63, t = piece >> 6, ks = t % nks, cb = t / nks;
    const int n = 32 * cb + (lane & 31), k0 = 16 * ks + 8 * (lane >> 5);
    float v[8];
#pragma unroll
    for (int j = 0; j < 8; ++j) v[j] = src(k0 + j, n);
    u32x4 o; o.x = pkbf(v[0], v[1]); o.y = pkbf(v[2], v[3]); o.z = pkbf(v[4], v[5]); o.w = pkbf(v[6], v[7]);
    *(u32x4*)(dst + (size_t)piece * 8) = o;
}
__device__ __forceinline__ void p0_prologue(const Params& p, Frame& F) {
    for (int u = F.vcu; u < 240; u += F.G) p0_mod_unit(p, F, u);
    float* scr = (float*)(F.lds + F.wave * 16384);
    const int rgw = F.ngw - 1 - F.gw;
    for (int it = rgw; it < 976 + 512; it += F.ngw) {
        if (it < 976) p0_transpose_item(p.w_in, DM, DIN, F.WinT, scr, it, F.lane);
        else p0_transpose_item(p.w_out, DM, DM, F.WoutT, scr, it - 976, F.lane);
    }
    const int gt = F.gw * 64 + F.lane, ngt = F.ngw * 64;
    for (int i = gt; i < 12288; i += ngt) *(u32x4*)(F.WinT + (size_t)DIN * DM + (size_t)i * 8) = (u32x4){0u, 0u, 0u, 0u};
    for (int i = gt; i < 24576; i += ngt) frag_piece(F.WuqF, i, 16, [&](int k, int n) { return p.w_uq[(size_t)k * 768 + n]; });
    for (int i = gt; i < 16384; i += ngt) frag_piece(F.WkvF, i, 8, [&](int k, int n) { return n < 512 ? p.w_uk[(size_t)k * 512 + n] : p.w_uv[(size_t)k * 512 + n - 512]; });
    for (int i = gt; i < 8192; i += ngt) { const int g = i >> 11; frag_piece(F.WpF + (size_t)g * 16384, i & 2047, 8, [&](int k, int n) { return p.w_pool[(size_t)(g * 128 + k) * 128 + n]; }); }
    for (int i = gt; i < 8193 * 16; i += ngt) {
        const int pi = i >> 4, fi = i & 15; const float pos = (pi < SEQ) ? (float)pi : 16384.f;
        const float ang = pos * ROPE_INV[fi];
        float s, c; sincos_d(ang, s, c);
        F.rope[(size_t)pi * 32 + fi] = c; F.rope[(size_t)pi * 32 + 16 + fi] = s;
    }
}

__device__ __forceinline__ void p1_hrows(const Params& p, Frame& F) {
    fresh(F);
    for (int row = F.gw; row < MT; row += F.ngw) {
        const float* xr; int mrow;
        if (row < MP) { xr = p.x_p + (size_t)row * DM; mrow = row >> 13; } else { xr = p.x_s + (size_t)(row - MP) * DM; mrow = 2 + (row - MP); }
        const float* mr = F.mod + (size_t)mrow * 3072;
        f32x4 v[4]; float ss = 0.f;
#pragma unroll
        for (int j = 0; j < 4; ++j) { v[j] = *(const f32x4*)(xr + 4 * (64 * j + F.lane)); ss += (v[j].x * v[j].x + v[j].y * v[j].y) + (v[j].z * v[j].z + v[j].w * v[j].w); }
        const float rstd = rsqrtf(wave_sum(ss) * (1.f / DM) + EPS);
        bf16_t* hr = F.H + (size_t)row * DM;
#pragma unroll
        for (int j = 0; j < 4; ++j) { const int c = 4 * (64 * j + F.lane);
            const f32x4 nw = *(const f32x4*)(p.norm_w + c), sh = *(const f32x4*)(mr + c), sc = *(const f32x4*)(mr + 1024 + c);
            const f32x4 h = (v[j] * rstd) * nw * (sc + 1.f) + sh;
            u32x2 o; o.x = pkbf(h.x, h.y); o.y = pkbf(h.z, h.w); *(u32x2*)(hr + c) = o; }
    }
}

template <class Epi>
__device__ __forceinline__ void small_gemm(const bf16_t* Wt, const bf16_t* A, int N, int K, int gw, int ngw, int lane, const Epi& epi) {
    const int ntile = (N >> 4) * 8, l15 = lane & 15, kb = lane >> 4;
    for (int t = gw; t < ntile; t += ngw) {
        const int ct = t >> 3, rt = t & 7;
        const bf16_t* wp = Wt + (size_t)(16 * ct + l15) * K + 8 * kb;
        const bf16_t* ap = A + (size_t)(16 * rt + l15) * K + 8 * kb;
        f32x4 acc = {0.f, 0.f, 0.f, 0.f};
#pragma unroll 8
        for (int ks = 0; ks < K / 32; ++ks) {
            const bf16x8 a = *(const bf16x8*)(wp + 32 * ks), b = *(const bf16x8*)(ap + 32 * ks);
            acc = __builtin_amdgcn_mfma_f32_16x16x32_bf16(a, b, acc, 0, 0, 0);
        }
        epi(16 * rt + l15, 16 * ct + 4 * kb, acc);
    }
}

template <int W>
__device__ __forceinline__ void pool_cols(const bf16_t* zc  , int t0, bf16_t* Pc  , float* npool  ) {
#pragma unroll 1
    for (int ch = 0; ch < 4; ++ch) {
        const int tb = t0 + 16 * ch;
        float v[16 + W - 1];
#pragma unroll
        for (int i = 0; i < 16 + W - 1; ++i) { const int t = tb - (W - 1) + i; v[i] = (t >= 0) ? bf2f(zc[(size_t)t * ZP]) : 0.f; }
#pragma unroll
        for (int r = 0; r < 16; ++r) {
            float s = 0.f;
#pragma unroll
            for (int j = 0; j < W; ++j) s += v[r + j];
            const int t = tb + r; const float u = v[r + W - 1];
            const float cnt = (t + 1 < W) ? (float)(t + 1) : (float)W;
            Pc[(16 * ch + r) * 520] = f2bf(s / cnt - u);
            if (npool && t >= SEQ - 15) npool[(size_t)(t - (SEQ - 15)) * DPOOL] = u;
        }
    }
}
__device__ __forceinline__ void p3_unit(const Params& p, Frame& F, int u) {
    fresh(F);
    const int b = u >> 7, tile = u & 127, t0 = tile * 64, grow0 = u * 64;
    const int lane = F.lane, wid = F.wave, r32 = lane & 31, hi = lane >> 5;
    bf16_t* Aq = (bf16_t*)F.lds;
    bf16_t* Ackv = (bf16_t*)(F.lds + 33792);
    bf16_t* KR = (bf16_t*)(F.lds + 51200);
    bf16_t* P = (bf16_t*)(F.lds + 55296);
    for (int rr = 0; rr < 8; ++rr) {
        const int row = 8 * wid + rr, grow = grow0 + row;
        const bf16_t* zr = F.Z + (size_t)grow * ZP;
        { const u32x2 raw = *(const u32x2*)(zr + OFF_Q + 4 * lane);
          const float v0 = bflo(raw.x), v1 = bfhi(raw.x), v2 = bflo(raw.y), v3 = bfhi(raw.y);
          const float rstd = rsqrtf(wave_sum((v0 * v0 + v1 * v1) + (v2 * v2 + v3 * v3)) * (1.f / QL) + EPS);
          const f32x4 nw = *(const f32x4*)(p.q_norm_w + 4 * lane);
          u32x2 o; o.x = pkbf(v0 * rstd * nw.x, v1 * rstd * nw.y); o.y = pkbf(v2 * rstd * nw.z, v3 * rstd * nw.w);
          *(u32x2*)(Aq + row * 264 + 4 * lane) = o; }
        { const unsigned raw = *(const unsigned*)(zr + OFF_KV + 2 * lane);
          const float v0 = bflo(raw), v1 = bfhi(raw);
          const float rstd = rsqrtf(wave_sum(v0 * v0 + v1 * v1) * (1.f / KVL) + EPS);
          const f32x2 nw = *(const f32x2*)(p.kv_norm_w + 2 * lane);
          const float c0 = v0 * rstd * nw.x, c1 = v1 * rstd * nw.y;
          *(f32x2*)(p.out + O_CKVP + (size_t)grow * KVL + 2 * lane) = (f32x2){c0, c1};
          *(unsigned*)(Ackv + row * 136 + 2 * lane) = pkbf(c0, c1); }
        if (lane < 16) {
            const float x1 = bf2f(zr[OFF_KR + lane]), x2 = bf2f(zr[OFF_KR + 16 + lane]);
            const float* tb = F.rope + (size_t)(t0 + row) * 32; const float c = tb[lane], s = tb[16 + lane];
            const float o1 = x1 * c - x2 * s, o2 = x2 * c + x1 * s;
            p.out[O_KRP + (size_t)grow * 32 + lane] = o1; p.out[O_KRP + (size_t)grow * 32 + 16 + lane] = o2;
            KR[row * 32 + lane] = f2bf(o1); KR[row * 32 + 16 + lane] = f2bf(o2);
        }
    }
    __syncthreads();
    for (int i = F.tid; i < 2048; i += 512) {
        const int h = i >> 8, ck = (i >> 6) & 3, row = i & 63;
        const u32x4 v = *(const u32x4*)(KR + row * 32 + 8 * ck);
        *(u32x4*)(F.Kt + ((size_t)((b * NH + h) * 128 + tile) * 12 + 8 + ck) * 512 + row * 8) = v;
    }
    const int h = wid, bh = b * NH + h;
    {
        f32x16 acc[2][3];
#pragma unroll
        for (int rb = 0; rb < 2; ++rb)
#pragma unroll
            for (int cb = 0; cb < 3; ++cb) acc[rb][cb] = f32x16{};
#pragma unroll 4
        for (int ks = 0; ks < 16; ++ks) {
            bf16x8 bfr[2], afr[3];
#pragma unroll
            for (int rb = 0; rb < 2; ++rb) bfr[rb] = *(const bf16x8*)(Aq + (32 * rb + r32) * 264 + 16 * ks + 8 * hi);
#pragma unroll
            for (int cb = 0; cb < 3; ++cb) afr[cb] = *(const bf16x8*)(F.WuqF + ((size_t)((3 * h + cb) * 16 + ks) * 64 + lane) * 8);
#pragma unroll
            for (int rb = 0; rb < 2; ++rb)
#pragma unroll
                for (int cb = 0; cb < 3; ++cb) acc[rb][cb] = __builtin_amdgcn_mfma_f32_32x32x16_bf16(afr[cb], bfr[rb], acc[rb][cb], 0, 0, 0);
        }
#pragma unroll
        for (int rb = 0; rb < 2; ++rb) {
            const int t = t0 + 32 * rb + r32;
            bf16_t* qrow = F.Q + ((size_t)bh * SEQ + t) * 96;
            const float* tb = F.rope + (size_t)t * 32;
            const f32x4 c0 = *(const f32x4*)(tb + 4 * hi), c1 = *(const f32x4*)(tb + 8 + 4 * hi), s0 = *(const f32x4*)(tb + 16 + 4 * hi), s1 = *(const f32x4*)(tb + 24 + 4 * hi);
            f32x16 rp = acc[rb][2];
#pragma unroll
            for (int r = 0; r < 8; ++r) { const float c = (r < 4) ? c0[r & 3] : c1[r & 3], s = (r < 4) ? s0[r & 3] : s1[r & 3];
                const float x1 = acc[rb][2][r], x2 = acc[rb][2][r + 8]; rp[r] = x1 * c - x2 * s; rp[r + 8] = x2 * c + x1 * s; }
#pragma unroll
            for (int cb = 0; cb < 3; ++cb) {
                const f32x16 a = (cb == 2) ? rp : acc[rb][cb];
#pragma unroll
                for (int g = 0; g < 4; ++g) { u32x2 o; o.x = pkbf(a[4 * g] * C2, a[4 * g + 1] * C2); o.y = pkbf(a[4 * g + 2] * C2, a[4 * g + 3] * C2);
                    *(u32x2*)(qrow + 32 * cb + 8 * g + 4 * hi) = o; }
            }
        }
    }
#pragma unroll 1
    for (int kv = 0; kv < 2; ++kv) {
        f32x16 acc[2][2];
#pragma unroll
        for (int rb = 0; rb < 2; ++rb)
#pragma unroll
            for (int cb = 0; cb < 2; ++cb) acc[rb][cb] = f32x16{};
#pragma unroll 4
        for (int ks = 0; ks < 8; ++ks) {
            bf16x8 bfr[2], afr[2];
#pragma unroll
            for (int rb = 0; rb < 2; ++rb) bfr[rb] = *(const bf16x8*)(Ackv + (32 * rb + r32) * 136 + 16 * ks + 8 * hi);
#pragma unroll
            for (int cb = 0; cb < 2; ++cb) afr[cb] = *(const bf16x8*)(F.WkvF + ((size_t)((16 * kv + 2 * h + cb) * 8 + ks) * 64 + lane) * 8);
#pragma unroll
            for (int rb = 0; rb < 2; ++rb)
#pragma unroll
                for (int cb = 0; cb < 2; ++cb) acc[rb][cb] = __builtin_amdgcn_mfma_f32_32x32x16_bf16(afr[cb], bfr[rb], acc[rb][cb], 0, 0, 0);
        }
#pragma unroll
        for (int rb = 0; rb < 2; ++rb) {
            const int row = 32 * rb + r32;
#pragma unroll
            for (int cb = 0; cb < 2; ++cb)
#pragma unroll
                for (int g = 0; g < 4; ++g) {
                    const f32x16& a = acc[rb][cb];
                    u32x2 o; o.x = pkbf(a[4 * g], a[4 * g + 1]); o.y = pkbf(a[4 * g + 2], a[4 * g + 3]);
                    if (kv == 0) {
                        *(u32x2*)(F.Kt + ((size_t)(bh * 128 + tile) * 12 + 4 * cb + g) * 512 + row * 8 + 4 * hi) = o;
                    } else {
                        const int kk = (row & ~0xC) | ((row & 4) << 1) | ((row & 8) >> 1);
                        *(u32x2*)(F.Vt + (size_t)(bh * 128 + tile) * 4096 + ((kk >> 3) * 2 + cb) * 256 + (kk & 7) * 32 + 8 * g + 4 * hi) = o;
                    }
                }
        }
    }
    {
        const int c = F.tid, g = wid >> 1;
        const bf16_t* zc = F.Z + (size_t)(b * SEQ) * ZP + OFF_U + c;
        float* npool = (tile == 127) ? (p.out + O_POOLP + (size_t)b * 15 * DPOOL + c) : nullptr;
        if (g == 0) pool_cols<2>(zc, t0, P + c, npool); else if (g == 1) pool_cols<4>(zc, t0, P + c, npool);
        else if (g == 2) pool_cols<8>(zc, t0, P + c, npool); else pool_cols<16>(zc, t0, P + c, npool);
    }
    __syncthreads();
    {
        const int g = wid >> 1, half = wid & 1;
        f32x16 acc[2][2];
#pragma unroll
        for (int rb = 0; rb < 2; ++rb)
#pragma unroll
            for (int cb = 0; cb < 2; ++cb) acc[rb][cb] = f32x16{};
#pragma unroll 4
        for (int ks = 0; ks < 8; ++ks) {
            bf16x8 bfr[2], afr[2];
#pragma unroll
            for (int rb = 0; rb < 2; ++rb) bfr[rb] = *(const bf16x8*)(P + (32 * rb + r32) * 520 + 128 * g + 16 * ks + 8 * hi);
#pragma unroll
            for (int cb = 0; cb < 2; ++cb) afr[cb] = *(const bf16x8*)(F.WpF + ((size_t)((g * 4 + 2 * half + cb) * 8 + ks) * 64 + lane) * 8);
#pragma unroll
            for (int rb = 0; rb < 2; ++rb)
#pragma unroll
                for (int cb = 0; cb < 2; ++cb) acc[rb][cb] = __builtin_amdgcn_mfma_f32_32x32x16_bf16(afr[cb], bfr[rb], acc[rb][cb], 0, 0, 0);
        }
#pragma unroll
        for (int rb = 0; rb < 2; ++rb) {
            const int grow = grow0 + 32 * rb + r32;
#pragma unroll
            for (int cb = 0; cb < 2; ++cb)
#pragma unroll
                for (int q = 0; q < 4; ++q) {
                    const int col = 128 * g + 32 * (2 * half + cb) + 8 * q + 4 * hi;
                    const f32x4 bp = *(const f32x4*)(p.b_pool + col), ps = *(const f32x4*)(p.pool_scale + col);
                    const u32x2 gr = *(const u32x2*)(F.Z + (size_t)grow * ZP + OFF_GP + col);
                    const f32x16& a = acc[rb][cb];
                    const float y0 = (a[4 * q] + bp.x) * ps.x * silu_f(bflo(gr.x)), y1 = (a[4 * q + 1] + bp.y) * ps.y * silu_f(bfhi(gr.x));
                    const float y2 = (a[4 * q + 2] + bp.z) * ps.z * silu_f(bflo(gr.y)), y3 = (a[4 * q + 3] + bp.w) * ps.w * silu_f(bfhi(gr.y));
                    u32x2 o; o.x = pkbf(y0, y1); o.y = pkbf(y2, y3);
                    *(u32x2*)(F.MIX + (size_t)grow * DM + 512 + col) = o;
                }
        }
    }
    __syncthreads();
}

namespace att {
constexpr int SHM_V = 8192, SHM_K = 12288, OFF_WS = 2 * SHM_V + 2 * SHM_K, OFF_STG = OFF_WS + 2048;
constexpr float THR = 8.f;
__device__ __forceinline__ void partialSM(f32x16& p0, f32x16& p1, float& m_reg, float& alpha) {
    float pmax = p0[0];
#pragma unroll
    for (int r = 1; r < 16; ++r) pmax = fmaxf(pmax, p0[r]);
#pragma unroll
    for (int r = 0; r < 16; ++r) pmax = fmaxf(pmax, p1[r]);
    { auto rr = __builtin_amdgcn_permlane32_swap(__float_as_uint(pmax), __float_as_uint(pmax), false, false);
      pmax = fmaxf(__uint_as_float(rr[0]), __uint_as_float(rr[1])); }
    float mn;
    if (__builtin_expect(__all(pmax - m_reg <= THR), 1)) { mn = m_reg; alpha = 1.f; }
    else { mn = fmaxf(m_reg, pmax); alpha = __builtin_amdgcn_exp2f(m_reg - mn); m_reg = mn; }
#pragma unroll
    for (int r = 0; r < 16; ++r) { p0[r] -= mn; p1[r] -= mn; }
#pragma unroll
    for (int r = 0; r < 16; ++r) p0[r] = __builtin_amdgcn_exp2f(p0[r]);
}
__device__ __forceinline__ void finishSM(f32x16& p0, f32x16& p1, float alpha, float& l_reg, bf16x8& pa0, bf16x8& pa1, bf16x8& pa2, bf16x8& pa3) {
#pragma unroll
    for (int r = 0; r < 16; ++r) p1[r] = __builtin_amdgcn_exp2f(p1[r]);
    float ps = 0.f;
#pragma unroll
    for (int r = 0; r < 16; ++r) ps += p0[r];
#pragma unroll
    for (int r = 0; r < 16; ++r) ps += p1[r];
    { auto rr = __builtin_amdgcn_permlane32_swap(__float_as_uint(ps), __float_as_uint(ps), false, false);
      ps = __uint_as_float(rr[0]) + __uint_as_float(rr[1]); }
    l_reg = l_reg * alpha + ps;
#define PK4(P, BASE, OUT) do { unsigned a0 = pkbf(P[BASE + 0], P[BASE + 1]), a1 = pkbf(P[BASE + 2], P[BASE + 3]);   \
    unsigned b0 = pkbf(P[BASE + 4], P[BASE + 5]), b1 = pkbf(P[BASE + 6], P[BASE + 7]);                              \
    auto r0 = __builtin_amdgcn_permlane32_swap(a0, b0, false, false); auto r1 = __builtin_amdgcn_permlane32_swap(a1, b1, false, false); \
    u32x4 w = {r0[0], r1[0], r0[1], r1[1]}; OUT = __builtin_bit_cast(bf16x8, w); } while (0)
    PK4(p0, 0, pa0); PK4(p0, 8, pa1); PK4(p1, 0, pa2); PK4(p1, 8, pa3);
#undef PK4
}
__device__ __forceinline__ void qkt(f32x16& p0, f32x16& p1, const char* Ks, const bf16x8* qr, int r32, int hi) {
    p0 = f32x16{}; p1 = f32x16{};
#pragma unroll
    for (int d0 = 0; d0 < 6; ++d0) {
        const bf16x8 b0 = *(const bf16x8*)(Ks + (2 * d0 + hi) * 1024 + r32 * 16);
        const bf16x8 b1 = *(const bf16x8*)(Ks + (2 * d0 + hi) * 1024 + 512 + r32 * 16);
        p0 = __builtin_amdgcn_mfma_f32_32x32x16_bf16(b0, qr[d0], p0, 0, 0, 0);
        p1 = __builtin_amdgcn_mfma_f32_32x32x16_bf16(b1, qr[d0], p1, 0, 0, 0); }
}
__device__ __forceinline__ void cmask(f32x16& p0, f32x16& p1, int jb, int qrel, int hi) {
    const float NEG = -INFINITY; const int kb = 64 * jb + 4 * hi;
#pragma unroll
    for (int r = 0; r < 16; ++r) { const int kv = kb + (r & 3) + 8 * (r >> 2); if (kv > qrel) p0[r] = NEG; if (kv + 32 > qrel) p1[r] = NEG; }
}
__device__ __forceinline__ int v_rd_base(int lane) { return ((lane & 3) << 3) | (((lane >> 2) & 3) << 6) | (((lane >> 4) & 1) << 5) | (((lane >> 5) & 1) << 8); }
constexpr int v_rd_off(int d0, int ks, int half) { return d0 * 512 + ks * 2048 + half * 1024; }
template <int OFF> __device__ __forceinline__ s16x4 tr_read(int vb) {
    s16x4 r; asm volatile("ds_read_b64_tr_b16 %0, %1 offset:%2" : "=&v"(r) : "v"(vb), "i"(OFF) : "memory"); return r;
}
template <int D0> __device__ __forceinline__ void pv_one(f32x16& od, int vb, bf16x8 pa0, bf16x8 pa1, bf16x8 pa2, bf16x8 pa3) {
    const s16x4 l0 = tr_read<v_rd_off(D0, 0, 0)>(vb), h0 = tr_read<v_rd_off(D0, 0, 1)>(vb), l1 = tr_read<v_rd_off(D0, 1, 0)>(vb), h1 = tr_read<v_rd_off(D0, 1, 1)>(vb);
    const s16x4 l2 = tr_read<v_rd_off(D0, 2, 0)>(vb), h2 = tr_read<v_rd_off(D0, 2, 1)>(vb), l3 = tr_read<v_rd_off(D0, 3, 0)>(vb), h3 = tr_read<v_rd_off(D0, 3, 1)>(vb);
    asm volatile("s_waitcnt lgkmcnt(0)" ::: "memory"); SBAR();
#define PK(L, H) (bf16x8){L[0], L[1], L[2], L[3], H[0], H[1], H[2], H[3]}
    od = __builtin_amdgcn_mfma_f32_32x32x16_bf16(pa0, PK(l0, h0), od, 0, 0, 0);
    od = __builtin_amdgcn_mfma_f32_32x32x16_bf16(pa1, PK(l1, h1), od, 0, 0, 0);
    od = __builtin_amdgcn_mfma_f32_32x32x16_bf16(pa2, PK(l2, h2), od, 0, 0, 0);
    od = __builtin_amdgcn_mfma_f32_32x32x16_bf16(pa3, PK(l3, h3), od, 0, 0, 0);
#undef PK
}
__device__ __forceinline__ void pv_d0(f32x16* o, int vb, bf16x8 pa0, bf16x8 pa1, bf16x8 pa2, bf16x8 pa3) {
    pv_one<0>(o[0], vb, pa0, pa1, pa2, pa3); pv_one<1>(o[1], vb, pa0, pa1, pa2, pa3);
}

__device__ __forceinline__ void attn_unit(Frame& F, int bh, int qb) {
    fresh(F);
    const int tid = F.tid, wid = F.wave, lane = F.lane, r32 = lane & 31, hi = lane >> 5;
    char* lds = (char*)F.lds;
    char* V_lds = lds; char* K_lds = lds + 2 * SHM_V;
    float* ws = (float*)(lds + OFF_WS) + wid * 64; float* li_l = ws; float* al_l = ws + 32;
    float* stg = (float*)(lds + OFF_STG) + wid * 2048;
    float m_reg = -1e30f, l_reg = 0.f; f32x16 o[2] = {}; bf16x8 qr[6];
    const int b = bh >> 3, h = bh & 7, q0 = qb * 256;
    const bf16_t* Qw = F.Q + ((size_t)bh * SEQ + q0 + wid * 32 + r32) * 96 + hi * 8;
#pragma unroll
    for (int d0 = 0; d0 < 6; ++d0) qr[d0] = *(const bf16x8*)(Qw + d0 * 16);
    const bf16_t* Kh = F.Kt + (size_t)(bh * 128) * 6144; const bf16_t* Vh = F.Vt + (size_t)(bh * 128) * 4096;
    const int vb0 = (int)(uintptr_t)V_lds + v_rd_base(lane);
    const int qrel = wid * 32 + r32;
    struct { bf16x8 ks0, ks1, vs0; } sr_[2];
#define SLOAD(i, j) do { const bf16_t* kt_ = Kh + (size_t)(j) * 6144; sr_[i].ks0 = *(const bf16x8*)(kt_ + tid * 8); if (tid < 256) sr_[i].ks1 = *(const bf16x8*)(kt_ + (512 + tid) * 8); \
    sr_[i].vs0 = *(const bf16x8*)(Vh + (size_t)(j) * 4096 + tid * 8); } while (0)
#define SWRITE(bb, i) do { *(bf16x8*)(K_lds + (bb) * SHM_K + tid * 16) = sr_[i].ks0; if (tid < 256) *(bf16x8*)(K_lds + (bb) * SHM_K + (512 + tid) * 16) = sr_[i].ks1; \
    *(bf16x8*)(V_lds + (bb) * SHM_V + tid * 16) = sr_[i].vs0; } while (0)
#define SWAIT() asm volatile("s_waitcnt vmcnt(3)" ::: "memory")
#define RESC(a) do { if (__any((a) < 1.f)) { if (hi == 0) al_l[r32] = (a); asm volatile("s_waitcnt lgkmcnt(0)" ::: "memory"); \
    _Pragma("unroll") for (int d = 0; d < 2; ++d) _Pragma("unroll") for (int r = 0; r < 16; ++r) o[d][r] *= al_l[crow(r, hi)]; } } while (0)
#define CMASK(P0, P1, j) do { const int jb_ = (j) - (NT - 4); if (jb_ >= 0) cmask(P0, P1, jb_, qrel, hi); } while (0)
    f32x16 pA0, pA1, pB0, pB1; float alA, alB; bf16x8 pa0, pa1, pa2, pa3; const int NT = 4 * (qb + 1);
    constexpr int SE = 0, SO = 1;
    SLOAD(SE, 0); asm volatile("s_waitcnt vmcnt(0)" ::: "memory"); SWRITE(0, SE); __syncthreads();
    qkt(pA0, pA1, K_lds, qr, r32, hi); CMASK(pA0, pA1, 0); partialSM(pA0, pA1, m_reg, alA);
    SLOAD(SO, 1); SLOAD(SE, 2);
    SWAIT(); SWRITE(1, SO); __syncthreads();
    for (int j = 1; j + 1 < NT; j += 2) {
        SBAR(); qkt(pB0, pB1, K_lds + SHM_K, qr, r32, hi); CMASK(pB0, pB1, j);
        finishSM(pA0, pA1, alA, l_reg, pa0, pa1, pa2, pa3); SBAR();
        SLOAD(SO, j + 2); SBAR();
        pv_d0(o, vb0, pa0, pa1, pa2, pa3); partialSM(pB0, pB1, m_reg, alB);
        __syncthreads(); SWAIT(); SWRITE(0, SE);
        RESC(alB); __syncthreads();
        SBAR(); qkt(pA0, pA1, K_lds, qr, r32, hi); CMASK(pA0, pA1, j + 1);
        finishSM(pB0, pB1, alB, l_reg, pa0, pa1, pa2, pa3); SBAR();
        if (j + 3 < NT) SLOAD(SE, j + 3); SBAR();
        pv_d0(o, vb0 + SHM_V, pa0, pa1, pa2, pa3); partialSM(pA0, pA1, m_reg, alA);
        __syncthreads(); SWAIT(); SWRITE(1, SO);
        RESC(alA); __syncthreads();
    }
    SBAR(); qkt(pB0, pB1, K_lds + SHM_K, qr, r32, hi); CMASK(pB0, pB1, NT - 1);
    finishSM(pA0, pA1, alA, l_reg, pa0, pa1, pa2, pa3); SBAR();
    pv_d0(o, vb0, pa0, pa1, pa2, pa3); partialSM(pB0, pB1, m_reg, alB);
    __syncthreads(); RESC(alB);
    finishSM(pB0, pB1, alB, l_reg, pa0, pa1, pa2, pa3); SBAR();
    pv_d0(o, vb0 + SHM_V, pa0, pa1, pa2, pa3);
    if (hi == 0) li_l[r32] = l_reg; asm volatile("s_waitcnt lgkmcnt(0)" ::: "memory");
    float rli[16];
#pragma unroll
    for (int r = 0; r < 16; ++r) rli[r] = __builtin_amdgcn_rcpf(li_l[crow(r, hi)]);
#pragma unroll
    for (int r = 0; r < 16; ++r) { const int orow = crow(r, hi);
#pragma unroll
        for (int d0 = 0; d0 < 2; ++d0) stg[orow * 64 + d0 * 32 + r32] = o[d0][r] * rli[r]; }
    asm volatile("s_waitcnt lgkmcnt(0)" ::: "memory");
    const size_t growb = (size_t)b * SEQ + q0 + wid * 32;
#pragma unroll
    for (int i = 0; i < 4; ++i) {
        const int row = i * 8 + (lane >> 3), ch = lane & 7;
        const f32x4 a = *(const f32x4*)(stg + row * 64 + ch * 8), c = *(const f32x4*)(stg + row * 64 + ch * 8 + 4);
        const u32x4 g = *(const u32x4*)(F.Z + (growb + row) * ZP + OFF_GA + 64 * h + 8 * ch);
        u32x4 w;
        w.x = pkbf(a.x * silu_f(bflo(g.x)), a.y * silu_f(bfhi(g.x))); w.y = pkbf(a.z * silu_f(bflo(g.y)), a.w * silu_f(bfhi(g.y)));
        w.z = pkbf(c.x * silu_f(bflo(g.z)), c.y * silu_f(bfhi(g.z))); w.w = pkbf(c.z * silu_f(bflo(g.w)), c.w * silu_f(bfhi(g.w)));
        *(u32x4*)(F.MIX + (growb + row) * DM + 64 * h + 8 * ch) = w;
    }
    asm volatile("s_waitcnt lgkmcnt(0)" ::: "memory");
    __syncthreads();
#undef SLOAD
#undef SWRITE
#undef SWAIT
#undef RESC
#undef CMASK
}
}

namespace dec {
typedef short v4i16_t __attribute__((ext_vector_type(4)));
constexpr float THR = 8.f;
__device__ __forceinline__ f32x4 ntld(const float* p) { return __builtin_nontemporal_load((const f32x4*)p); }
__device__ __forceinline__ s16x4 vtr(const LAS unsigned char* p) { return __builtin_bit_cast(s16x4, __builtin_amdgcn_ds_read_tr16_b64_v4i16((LAS v4i16_t*)p)); }

__device__ __forceinline__ void decode_unit(const Params& p, Frame& F, int b, int hf) {
    fresh(F);
    const int tid = F.tid, wid = F.wave, lane = F.lane;
    LAS unsigned char* ldsl = (LAS unsigned char*)F.lds;
    float* fl = (float*)(F.lds + 65536);
    float* qlat = fl; float* ckvn = fl + 256; float* krn = fl + 384; float* qpart = fl + 416; float* qf = fl + 1952; float* qa = fl + 2720; float* qrp = fl + 3744; float* pooled = fl + 4000;
    int* pids = (int*)(fl + 4512);
    const bf16_t* zrow = F.Z + (size_t)(MP + b) * ZP;
    const float* tab = F.rope + (size_t)SEQ * 32;
    if (wid == 0) {
        const u32x2 raw = *(const u32x2*)(zrow + OFF_Q + 4 * lane);
        const float v0 = bflo(raw.x), v1 = bfhi(raw.x), v2 = bflo(raw.y), v3 = bfhi(raw.y);
        const float rstd = rsqrtf(wave_sum((v0 * v0 + v1 * v1) + (v2 * v2 + v3 * v3)) * (1.f / QL) + EPS);
        const f32x4 nw = *(const f32x4*)(p.q_norm_w + 4 * lane);
        *(f32x4*)(qlat + 4 * lane) = (f32x4){v0 * rstd * nw.x, v1 * rstd * nw.y, v2 * rstd * nw.z, v3 * rstd * nw.w};
    } else if (wid == 1) {
        const unsigned raw = *(const unsigned*)(zrow + OFF_KV + 2 * lane);
        const float v0 = bflo(raw), v1 = bfhi(raw);
        const float rstd = rsqrtf(wave_sum(v0 * v0 + v1 * v1) * (1.f / KVL) + EPS);
        const f32x2 nw = *(const f32x2*)(p.kv_norm_w + 2 * lane);
        const float c0 = v0 * rstd * nw.x, c1 = v1 * rstd * nw.y;
        ckvn[2 * lane] = c0; ckvn[2 * lane + 1] = c1;
        if (hf == 0) { *(f32x2*)(p.out + O_CKVS + (size_t)b * KVL + 2 * lane) = (f32x2){c0, c1}; *(f32x2*)(F.samp + (size_t)b * 256 + 2 * lane) = (f32x2){c0, c1}; }
    } else if (wid == 2) {
        if (lane < 16) {
            const float x1 = bf2f(zrow[OFF_KR + lane]), x2 = bf2f(zrow[OFF_KR + 16 + lane]);
            const float c = tab[lane], s = tab[16 + lane];
            const float o1 = x1 * c - x2 * s, o2 = x2 * c + x1 * s;
            krn[lane] = o1; krn[16 + lane] = o2;
            if (hf == 0) { p.out[O_KRS + (size_t)b * 32 + lane] = o1; p.out[O_KRS + (size_t)b * 32 + 16 + lane] = o2; }
        }
    }
    if (lane < 8) pids[wid * 8 + lane] = p.page_table[b * 128 + 64 * hf + 8 * wid + lane];
    __syncthreads();
    {
        const int n = tid & 255, kh = tid >> 8; float a0 = 0.f, a1 = 0.f, a2 = 0.f;
        const float* wq = p.w_uq + (size_t)(128 * kh) * 768 + n;
#pragma unroll 8
        for (int k = 0; k < 128; ++k) { const float x = qlat[128 * kh + k]; a0 += x * wq[(size_t)k * 768]; a1 += x * wq[(size_t)k * 768 + 256]; a2 += x * wq[(size_t)k * 768 + 512]; }
        qpart[kh * 768 + n] = a0; qpart[kh * 768 + 256 + n] = a1; qpart[kh * 768 + 512 + n] = a2;
    }
    __syncthreads();
    for (int n = tid; n < 768; n += 512) qf[n] = qpart[n] + qpart[768 + n];
    __syncthreads();
    if (tid < 128) {
        const int h = tid >> 4, i = tid & 15; const float x1 = qf[96 * h + 64 + i], x2 = qf[96 * h + 80 + i], c = tab[i], s = tab[16 + i];
        qrp[h * 32 + i] = (x1 * c - x2 * s) * C2; qrp[h * 32 + 16 + i] = (x2 * c + x1 * s) * C2;
    }
    for (int oo = tid; oo < 1024; oo += 512) {
        const int h = oo >> 7, k = oo & 127; const float* wk = p.w_uk + (size_t)k * 512 + h * 64; float acc = 0.f;
#pragma unroll
        for (int d4 = 0; d4 < 16; ++d4) { const f32x4 w = *(const f32x4*)(wk + 4 * d4); const f32x4 q = *(const f32x4*)(qf + 96 * h + 4 * d4); acc += (q.x * w.x + q.y * w.y) + (q.z * w.z + q.w * w.w); }
        qa[oo] = acc * C2;
    }
    __syncthreads();
    if (hf == 0 && tid < 8) {
        float s = 0.f;
        for (int k = 0; k < 128; ++k) s += qa[tid * 128 + k] * ckvn[k];
        for (int i = 0; i < 32; ++i) s += qrp[tid * 32 + i] * krn[i];
        F.samp[(size_t)b * 256 + 128 + tid] = s;
    }
    if (hf == 0) {
        for (int j = 0; j < 14; ++j) p.out[O_POOLS + ((size_t)b * 15 + j) * DPOOL + tid] = p.state_pool[((size_t)b * 15 + j + 1) * DPOOL + tid];
        p.out[O_POOLS + ((size_t)b * 15 + 14) * DPOOL + tid] = bf2f(zrow[OFF_U + tid]);
    } else {
        const int c = tid, g = c >> 7, w = 2 << g; const float u = bf2f(zrow[OFF_U + c]); float s = u;
        for (int j = 1; j < w; ++j) s += p.state_pool[((size_t)b * 15 + 15 - j) * DPOOL + c];
        pooled[c] = s / (float)w - u;
    }
    __syncthreads();
    if (hf == 1) {
        const int g = tid >> 7, d = tid & 127; float acc = 0.f; const float* wp = p.w_pool + (size_t)(g * 128) * 128 + d;
#pragma unroll 8
        for (int c = 0; c < 128; ++c) acc += pooled[g * 128 + c] * wp[(size_t)c * 128];
        const float y = (acc + p.b_pool[tid]) * p.pool_scale[tid] * silu_f(bf2f(zrow[OFF_GP + tid]));
        F.MIX[(size_t)(MP + b) * DM + 512 + tid] = f2bf(y);
    }
    const int n16 = lane & 15, kb = lane >> 4;
    bf16x8 qfr[5];
#pragma unroll
    for (int j = 0; j < 5; ++j) {
        float v[8];
#pragma unroll
        for (int i = 0; i < 4; ++i) {
            if (j < 4) { v[i] = (n16 < 8) ? qa[n16 * 128 + 32 * j + 4 * kb + i] : 0.f; v[4 + i] = (n16 < 8) ? qa[n16 * 128 + 32 * j + 16 + 4 * kb + i] : 0.f; }
            else       { v[i] = (n16 < 8) ? qrp[n16 * 32 + 4 * kb + i] : 0.f;           v[4 + i] = (n16 < 8) ? qrp[n16 * 32 + 16 + 4 * kb + i] : 0.f; }
        }
        u32x4 w = {pkbf(v[0], v[1]), pkbf(v[2], v[3]), pkbf(v[4], v[5]), pkbf(v[6], v[7])};
        qfr[j] = __builtin_bit_cast(bf16x8, w);
    }
    LAS unsigned char* wl = ldsl + wid * 8192;
    const int key = n16;
    const int swzw = ((key & 7) << 2) | (key >> 3);
    const int wr_off = key * 256;
    const int q4 = (lane >> 2) & 3, p4 = lane & 3, rrow = 4 * kb + q4, swzr = ((rrow & 7) << 2) | (rrow >> 3);
    const int rd_off = rrow * 256;
    const size_t koff = (size_t)key * 128 + 4 * kb, kroff = (size_t)key * 32 + 4 * kb;
    f32x4 o[8];
#pragma unroll
    for (int d = 0; d < 8; ++d) o[d] = (f32x4){0.f, 0.f, 0.f, 0.f};
    float m_reg = -1e30f, l_reg = 0.f;
    f32x4 ldA[10], ldB[10];
#define ISSUE(dst, st, T) do { const int pid_ = __builtin_amdgcn_readfirstlane(pids[wid * 8 + ((st) >> 2)]); const int krow_ = 32 * ((st) & 3) + 16 * (T); \
    const float* cb_ = p.cache_ckv + (size_t)pid_ * 16384 + (size_t)krow_ * 128 + koff; const float* kr_ = p.cache_kr + (size_t)pid_ * 4096 + (size_t)krow_ * 32 + kroff; \
    _Pragma("unroll") for (int e = 0; e < 8; ++e) dst[e] = ntld(cb_ + 16 * e); dst[8] = ntld(kr_); dst[9] = ntld(kr_ + 16); } while (0)
#define PROCESS(src, T, S) do { unsigned w_[20]; \
    _Pragma("unroll") for (int e = 0; e < 10; ++e) { w_[2 * e] = pkbf(src[e].x, src[e].y); w_[2 * e + 1] = pkbf(src[e].z, src[e].w); } \
    S = (f32x4){0.f, 0.f, 0.f, 0.f}; \
    _Pragma("unroll") for (int j = 0; j < 5; ++j) { const u32x4 kf_ = {w_[4 * j], w_[4 * j + 1], w_[4 * j + 2], w_[4 * j + 3]}; \
        S = __builtin_amdgcn_mfma_f32_16x16x32_bf16(__builtin_bit_cast(bf16x8, kf_), qfr[j], S, 0, 0, 0); } \
    _Pragma("unroll") for (int e = 0; e < 8; ++e) *(LAS u32x2*)(wl + (T) * 4096 + wr_off + (((4 * e + kb) ^ swzw) << 3)) = (u32x2){w_[2 * e], w_[2 * e + 1]}; } while (0)
    ISSUE(ldA, 0, 0); ISSUE(ldB, 0, 1);
#pragma unroll 1
    for (int st = 0; st < 32; ++st) {
        f32x4 s0, s1;
        PROCESS(ldA, 0, s0);
        if (st + 1 < 32) ISSUE(ldA, st + 1, 0);
        PROCESS(ldB, 1, s1);
        if (st + 1 < 32) ISSUE(ldB, st + 1, 1);
        float tmax = fmaxf(fmaxf(fmaxf(s0.x, s0.y), fmaxf(s0.z, s0.w)), fmaxf(fmaxf(s1.x, s1.y), fmaxf(s1.z, s1.w)));
        tmax = fmaxf(tmax, __shfl_xor(tmax, 16)); tmax = fmaxf(tmax, __shfl_xor(tmax, 32));
        if (__any(tmax - m_reg > THR)) {
            const float mn = fmaxf(m_reg, tmax), alpha = __builtin_amdgcn_exp2f(m_reg - mn); m_reg = mn; l_reg *= alpha;
#pragma unroll
            for (int d = 0; d < 8; ++d) o[d] *= alpha;
        }
        const float p0 = __builtin_amdgcn_exp2f(s0.x - m_reg), p1 = __builtin_amdgcn_exp2f(s0.y - m_reg), p2 = __builtin_amdgcn_exp2f(s0.z - m_reg), p3 = __builtin_amdgcn_exp2f(s0.w - m_reg);
        const float p4_ = __builtin_amdgcn_exp2f(s1.x - m_reg), p5 = __builtin_amdgcn_exp2f(s1.y - m_reg), p6 = __builtin_amdgcn_exp2f(s1.z - m_reg), p7 = __builtin_amdgcn_exp2f(s1.w - m_reg);
        l_reg += ((p0 + p1) + (p2 + p3)) + ((p4_ + p5) + (p6 + p7));
        const u32x4 pw = {pkbf(p0, p1), pkbf(p2, p3), pkbf(p4_, p5), pkbf(p6, p7)};
        const bf16x8 pfr = __builtin_bit_cast(bf16x8, pw);
#pragma unroll
        for (int db = 0; db < 8; ++db) {
            const int off = rd_off + (((4 * db + p4) ^ swzr) << 3);
            const s16x4 lo = vtr(wl + off), hi4 = vtr(wl + 4096 + off);
            const bf16x8 vf = (bf16x8){lo[0], lo[1], lo[2], lo[3], hi4[0], hi4[1], hi4[2], hi4[3]};
            o[db] = __builtin_amdgcn_mfma_f32_16x16x32_bf16(vf, pfr, o[db], 0, 0, 0);
        }
    }
#undef ISSUE
#undef PROCESS
    l_reg += __shfl_xor(l_reg, 16); l_reg += __shfl_xor(l_reg, 32);
    __syncthreads();
    float* wpart = (float*)F.lds;
    if (n16 < 8) {
#pragma unroll
        for (int db = 0; db < 8; ++db) *(f32x4*)(wpart + (wid * 8 + n16) * 132 + 16 * db + 4 * kb) = o[db];
        if (kb == 0) { wpart[(wid * 8 + n16) * 132 + 128] = m_reg; wpart[(wid * 8 + n16) * 132 + 129] = l_reg; }
    }
    __syncthreads();
    float* pout = F.part + (size_t)(b * 2 + hf) * 8 * 132;
    for (int oo = tid; oo < 1024; oo += 512) {
        const int h = oo >> 7, k = oo & 127;
        float M = -1e30f;
#pragma unroll
        for (int w = 0; w < 8; ++w) M = fmaxf(M, wpart[(w * 8 + h) * 132 + 128]);
        float O = 0.f, L = 0.f;
#pragma unroll
        for (int w = 0; w < 8; ++w) { const float f = __builtin_amdgcn_exp2f(wpart[(w * 8 + h) * 132 + 128] - M); O += f * wpart[(w * 8 + h) * 132 + k]; L += f * wpart[(w * 8 + h) * 132 + 129]; }
        pout[h * 132 + k] = O;
        if (k == 0) { pout[h * 132 + 128] = M; pout[h * 132 + 129] = L; }
    }
    __syncthreads();
}

__device__ __forceinline__ void combine_unit(const Params& p, Frame& F, int b) {
    fresh(F);
    const int tid = F.tid;
    float* olat = (float*)F.lds;
    const float* p0 = F.part + (size_t)(b * 2) * 8 * 132; const float* p1 = p0 + 8 * 132;
    for (int oo = tid; oo < 1024; oo += 512) {
        const int h = oo >> 7, k = oo & 127;
        const float m0 = p0[h * 132 + 128], m1 = p1[h * 132 + 128], sn = F.samp[(size_t)b * 256 + 128 + h];
        const float M = fmaxf(fmaxf(m0, m1), sn);
        const float f0 = __builtin_amdgcn_exp2f(m0 - M), f1 = __builtin_amdgcn_exp2f(m1 - M), fn = __builtin_amdgcn_exp2f(sn - M);
        const float L = f0 * p0[h * 132 + 129] + f1 * p1[h * 132 + 129] + fn;
        olat[oo] = (f0 * p0[h * 132 + k] + f1 * p1[h * 132 + k] + fn * F.samp[(size_t)b * 256 + k]) / L;
    }
    __syncthreads();
    {
        const int h = tid >> 6; float acc = 0.f; const float* wv = p.w_uv + tid;
#pragma unroll 8
        for (int k = 0; k < 128; ++k) acc += olat[h * 128 + k] * wv[(size_t)k * 512];
        const float g = bf2f(F.Z[(size_t)(MP + b) * ZP + OFF_GA + tid]);
        F.MIX[(size_t)(MP + b) * DM + tid] = f2bf(acc * silu_f(g));
    }
    __syncthreads();
}
}

__device__ __forceinline__ void p6_norm(const Params& p, Frame& F) {
    fresh(F);
    for (int row = F.gw; row < MT; row += F.ngw) {
        float* xr = (row < MP) ? (p.out + O_YP + (size_t)row * DM) : (p.out + O_YS + (size_t)(row - MP) * DM);
        f32x4 v[4]; float ss = 0.f;
#pragma unroll
        for (int j = 0; j < 4; ++j) { v[j] = *(const f32x4*)(xr + 4 * (64 * j + F.lane)); ss += (v[j].x * v[j].x + v[j].y * v[j].y) + (v[j].z * v[j].z + v[j].w * v[j].w); }
        const float rstd = rsqrtf(wave_sum(ss) * (1.f / DM) + EPS);
#pragma unroll
        for (int j = 0; j < 4; ++j) { const int c = 4 * (64 * j + F.lane); const f32x4 nw = *(const f32x4*)(p.final_norm_w + c); *(f32x4*)(xr + c) = (v[j] * rstd) * nw; }
    }
}

__global__ void __launch_bounds__(512, 2) hymba_fwd(Params p) {
    extern __shared__ __attribute__((aligned(16))) unsigned char lds_raw[];
    Frame F;
    F.lds = lds_raw;
    F.tid = threadIdx.x; F.lane = F.tid & 63; F.wave = __builtin_amdgcn_readfirstlane(F.tid >> 6);
    F.G = gridDim.x; { const int bx = blockIdx.x; F.vcu = (F.G % 8 == 0) ? (bx % 8) * (F.G / 8) + bx / 8 : bx; }
    F.gw = F.vcu * 8 + F.wave; F.ngw = F.G * 8;
    unsigned char* ws = p.ws;
    F.mod = (float*)(ws + WS_MOD); F.rope = (float*)(ws + WS_ROPE); F.WinT = (bf16_t*)(ws + WS_WIN); F.WoutT = (bf16_t*)(ws + WS_WOUT);
    F.WuqF = (bf16_t*)(ws + WS_WUQF); F.WkvF = (bf16_t*)(ws + WS_WKVF); F.WpF = (bf16_t*)(ws + WS_WPF);
    F.part = (float*)(ws + WS_PART); F.samp = (float*)(ws + WS_SAMP); F.H = (bf16_t*)(ws + WS_H); F.Z = (bf16_t*)(ws + WS_Z);
    F.Q = (bf16_t*)(ws + WS_Q); F.Kt = (bf16_t*)(ws + WS_K); F.Vt = (bf16_t*)(ws + WS_V); F.MIX = (bf16_t*)(ws + WS_MIX);
    LAS unsigned char* ldsl = (LAS unsigned char*)lds_raw;
    volatile LAS unsigned* MISC = (volatile LAS unsigned*)(ldsl + MISC_OFF);
    for (int u = F.tid; u < (LDS_BYTES - LDSCTL_OFF) / 4; u += 512) ((LAS unsigned*)(ldsl + LDSCTL_OFF))[u] = 0u;
    __syncthreads();
    unsigned* barw = (unsigned*)(ws + WS_CTL) + CW_BAR;
    XcdBarrier bar; bar.bar = barw; bar.x = 0; bar.st = nullptr;
    if (MK_N_LAUNCHES == 1) bar = xcd_barrier_post(barw, MISC + 8);
    const int lo = p.ph_lo, hi = p.ph_hi;
#ifndef PH_MASK
#define PH_MASK 255
#endif
#define IN(k) ((((PH_MASK) >> (k)) & 1) && lo <= (k) && (k) < hi)
#define SEAM(k) do { if (IN(k) && IN((k) + 1)) xcd_barrier(bar); } while (0)

    if (IN(0)) { p0_prologue(p, F); }
    SEAM(0);
    if (IN(1)) { p1_hrows(p, F); }
    SEAM(1);
    if (IN(2)) {
        {
            bf16_t* Zs = F.Z + (size_t)MP * ZP;
            small_gemm(F.WinT, F.H + (size_t)MP * DM, DIN, DM, F.gw, F.ngw, F.lane, [&](int row, int col, const f32x4& a) {
                u32x2 o; o.x = pkbf(a.x, a.y); o.y = pkbf(a.z, a.w); *(u32x2*)(Zs + (size_t)row * ZP + col) = o; });
        }
        pg8::Gemm g{F.H, F.WinT, MP, ZP, DM}; pg8::StaticOrder S; S.init(MP, ZP, F.G, (int)blockIdx.x);
        pg8::EpiBf16 E{F.Z, ZP};
        pg8::gemm_phase<pg8::EpiBf16, pg8::StaticOrder, true, true>(ldsl, g, S, E);
    }
    SEAM(2);
    if (IN(3)) { for (int u = F.vcu; u < 256; u += F.G) p3_unit(p, F, u); }
    SEAM(3);
    if (IN(4)) {
#ifndef NO_ATT
        for (int pr = F.vcu; pr < 256; pr += F.G) { const int bh = pr >> 4, s = pr & 15; att::attn_unit(F, bh, 31 - s); att::attn_unit(F, bh, s); }
#endif
#ifndef NO_DEC
        for (int wu = F.vcu; wu < 256; wu += F.G) dec::decode_unit(p, F, wu >> 1, wu & 1);
#endif
    }
    SEAM(4);
    if (IN(5)) { for (int b = F.vcu; b < DB; b += F.G) dec::combine_unit(p, F, b); }
    SEAM(5);
    if (IN(6)) {
        {
            small_gemm(F.WoutT, F.MIX + (size_t)MP * DM, DM, DM, F.gw, F.ngw, F.lane, [&](int row, int col, const f32x4& a) {
                const f32x4 g = *(const f32x4*)(F.mod + (size_t)(2 + row) * 3072 + 2048 + col), xv = *(const f32x4*)(p.x_s + (size_t)row * DM + col);
                *(f32x4*)(p.out + O_YS + (size_t)row * DM + col) = xv + g * a; });
        }
        pg8::Gemm g{F.MIX, F.WoutT, MP, DM, DM}; pg8::StaticOrder S; S.init(MP, DM, F.G, (int)blockIdx.x);
        pg8::EpiOut E{p.x_p, F.mod, p.out + O_YP};
        pg8::gemm_phase<pg8::EpiOut, pg8::StaticOrder, false, true>(ldsl, g, S, E);
    }
    SEAM(6);
    if (IN(7)) { p6_norm(p, F); }
#undef IN
#undef SEAM
}

extern "C" void kernel_launch(void* const* d_in, const int* in_sizes, int n_in, void* d_out, int out_size, void* d_ws, size_t ws_size, hipStream_t stream) {
    static int grid = 0;
    if (grid == 0) {
        if (n_in != 22 || ws_size < WS_END) { fprintf(stderr, "kernel_launch: unexpected inputs (n_in %d, ws %zu)\n", n_in, ws_size); grid = -1; return; }
        int dev = 0, cus = 0;
        if (hipGetDevice(&dev) != hipSuccess || hipDeviceGetAttribute(&cus, hipDeviceAttributeMultiprocessorCount, dev) != hipSuccess) { grid = -1; return; }
        if (hipFuncSetAttribute((const void*)hymba_fwd, hipFuncAttributeMaxDynamicSharedMemorySize, LDS_BYTES) != hipSuccess) { fprintf(stderr, "kernel_launch: hipFuncSetAttribute failed\n"); grid = -1; return; }
        int per_cu = 0;
        if (hipOccupancyMaxActiveBlocksPerMultiprocessor(&per_cu, (const void*)hymba_fwd, 512, LDS_BYTES) != hipSuccess || per_cu < 1) fprintf(stderr, "kernel_launch: occupancy query reports %d\n", per_cu);
        (void)hipGetLastError();
        grid = cus;
    }
    if (grid < 0) return;
    (void)hipMemsetAsync((char*)d_ws + WS_CTL, 0, CTL_ZERO_BYTES, stream);
    Params p{};
    p.x_p = (const float*)d_in[0]; p.x_s = (const float*)d_in[1]; p.c_p = (const float*)d_in[2]; p.c_s = (const float*)d_in[3];
    p.cache_ckv = (const float*)d_in[4]; p.cache_kr = (const float*)d_in[5]; p.state_pool = (const float*)d_in[6]; p.page_table = (const int*)d_in[7];
    p.ada_w = (const float*)d_in[8]; p.ada_b = (const float*)d_in[9]; p.norm_w = (const float*)d_in[10]; p.w_in = (const float*)d_in[11]; p.q_norm_w = (const float*)d_in[12];
    p.w_uq = (const float*)d_in[13]; p.kv_norm_w = (const float*)d_in[14]; p.w_uk = (const float*)d_in[15]; p.w_uv = (const float*)d_in[16]; p.w_pool = (const float*)d_in[17];
    p.b_pool = (const float*)d_in[18]; p.pool_scale = (const float*)d_in[19]; p.w_out = (const float*)d_in[20]; p.final_norm_w = (const float*)d_in[21];
    p.out = (float*)d_out; p.ws = (unsigned char*)d_ws;
    if (MK_N_LAUNCHES == 1) {
        p.ph_lo = 0; p.ph_hi = N_PHASES;
        hipLaunchKernelGGL(hymba_fwd, dim3(grid), dim3(512), LDS_BYTES, stream, p);
    } else {
        for (int k = 0; k < N_PHASES; ++k) { p.ph_lo = k; p.ph_hi = k + 1; hipLaunchKernelGGL(hymba_fwd, dim3(grid), dim3(512), LDS_BYTES, stream, p); }
    }
    const hipError_t le = hipPeekAtLastError();
    if (le != hipSuccess) fprintf(stderr, "kernel_launch: launch failed: %s\n", hipGetErrorName(le));
}
```
